# Optimizing an MI355X kernel written in HIP

```python
import math
import jax, jax.numpy as jnp
from jax import lax
import numpy as np

D_MODEL = 1024
BATCH = 8
SEQ = 2048
DEPTH = 1
DEC_BATCH = 128
DEC_SEQ = 4
PAST_LEN = 16384
PAGE_SIZE = 128

POOL_WIDTH = D_MODEL // 2
POOL_WINDOWS = (2, 4, 8, 16)
POOL_GROUPS = len(POOL_WINDOWS)
POOL_GROUP_DIM = POOL_WIDTH // POOL_GROUPS
POOL_HIST = max(POOL_WINDOWS) - 1
SSM_WIDTH = D_MODEL // 2
SSM_GROUP_DIM = 16
SSM_GROUPS = SSM_WIDTH // SSM_GROUP_DIM
SSM_STATE = 64
DT_MIN = 0.001
DT_MAX = 0.1
N_BRANCHES = 2
IN_WIDTH = POOL_WIDTH + SSM_WIDTH + N_BRANCHES * D_MODEL
D_FF = -(-8 * D_MODEL // (3 * 256)) * 256
RMS_EPS = 1e-6

kernel_name = 'hybrid_pool_s5_gated_decoder_step'


def _rmsnorm(x, g):
    xf = x.astype(jnp.float32)
    y = xf * lax.rsqrt(jnp.mean(xf * xf, axis=-1, keepdims=True) + RMS_EPS)
    return (y * g.astype(jnp.float32)).astype(x.dtype)


def _pool_mixer(u_hist, u, start_pos, w_grp, scale):
    b, t, c = u.shape
    ext = jnp.concatenate([u_hist.astype(jnp.float32), u.astype(jnp.float32)], axis=1)
    cs = jnp.concatenate([jnp.zeros((b, 1, c), jnp.float32), jnp.cumsum(ext, axis=1)], axis=1)
    pos = start_pos + jnp.arange(t)
    base = POOL_HIST + 1
    pooled = []
    for g, w in enumerate(POOL_WINDOWS):
        lo_c, hi_c = g * POOL_GROUP_DIM, (g + 1) * POOL_GROUP_DIM
        win_sum = cs[:, base:base + t, lo_c:hi_c] - cs[:, base - w:base - w + t, lo_c:hi_c]
        cnt = jnp.minimum(w, pos + 1).astype(jnp.float32)[None, :, None]
        pooled.append(win_sum / cnt)
    pooled = jnp.stack(pooled, axis=2)
    diff = pooled - u.astype(jnp.float32).reshape(b, t, POOL_GROUPS, POOL_GROUP_DIM)
    mixed = jnp.einsum('btgc,gcd->btgd', diff, w_grp.astype(jnp.float32))
    return (mixed.reshape(b, t, c) * scale.astype(jnp.float32)).astype(u.dtype)


def _s5_discretise(a_re, a_im, log_dt):
    a_re = a_re.astype(jnp.float32)
    a_im = a_im.astype(jnp.float32)
    dt = jnp.exp(log_dt.astype(jnp.float32))[:, None]
    mag = jnp.exp(a_re * dt)
    ab_re = mag * jnp.cos(a_im * dt)
    ab_im = mag * jnp.sin(a_im * dt)
    num_re = ab_re - 1.0
    num_im = ab_im
    den = a_re * a_re + a_im * a_im
    coef_re = (num_re * a_re + num_im * a_im) / den
    coef_im = (num_im * a_re - num_re * a_im) / den
    return ab_re, ab_im, coef_re, coef_im


def _scan_combine(e1, e2):
    a1r, a1i, b1r, b1i = e1
    a2r, a2i, b2r, b2i = e2
    ar = a2r * a1r - a2i * a1i
    ai = a2r * a1i + a2i * a1r
    br = a2r * b1r - a2i * b1i + b2r
    bi = a2r * b1i + a2i * b1r + b2i
    return ar, ai, br, bi


def _s5_mixer(u, h_re, h_im, a_re, a_im, log_dt, b_re, b_im, c_re, c_im, d_skip):
    b, t, _ = u.shape
    uf = u.astype(jnp.float32)
    ug = uf.reshape(b, t, SSM_GROUPS, SSM_GROUP_DIM)
    ab_re, ab_im, coef_re, coef_im = _s5_discretise(a_re, a_im, log_dt)
    bu_re = jnp.einsum('btgh,gph->btgp', ug, b_re.astype(jnp.float32))
    bu_im = jnp.einsum('btgh,gph->btgp', ug, b_im.astype(jnp.float32))
    x_re = coef_re * bu_re - coef_im * bu_im
    x_im = coef_re * bu_im + coef_im * bu_re
    h_re = h_re.astype(jnp.float32)
    h_im = h_im.astype(jnp.float32)
    x_re = x_re.at[:, 0].add(ab_re * h_re - ab_im * h_im)
    x_im = x_im.at[:, 0].add(ab_re * h_im + ab_im * h_re)
    a_re_b = jnp.broadcast_to(ab_re, x_re.shape)
    a_im_b = jnp.broadcast_to(ab_im, x_im.shape)
    _, _, s_re, s_im = lax.associative_scan(_scan_combine, (a_re_b, a_im_b, x_re, x_im), axis=1)
    y = (jnp.einsum('btgp,ghp->btgh', s_re, c_re.astype(jnp.float32))
         - jnp.einsum('btgp,ghp->btgh', s_im, c_im.astype(jnp.float32)))
    y = y.reshape(b, t, SSM_WIDTH) + d_skip.astype(jnp.float32) * uf
    return y, s_re[:, -1], s_im[:, -1]


def _trunk(x, hist, st_re, st_im, start_pos, norm_mix, w_in, pool_w, pool_scale,
           ssm_a_re, ssm_a_im, ssm_log_dt, ssm_b_re, ssm_b_im, ssm_c_re, ssm_c_im, ssm_d,
           glu_w, glu_b, w_branch_pool, w_branch_ssm, w_out, norm_ffn,
           ffn_w_gate, ffn_w_up, ffn_w_down, norm_final):
    h = x
    b, t, _ = x.shape
    new_hist, new_re, new_im = [], [], []
    for l in range(DEPTH):
        xn = _rmsnorm(h, norm_mix[l])
        proj = jnp.einsum('btd,de->bte', xn, w_in[l])
        u_pool = proj[..., :POOL_WIDTH]
        u_ssm = proj[..., POOL_WIDTH:POOL_WIDTH + SSM_WIDTH]
        gates = jax.nn.sigmoid(proj[..., POOL_WIDTH + SSM_WIDTH:].astype(jnp.float32)
                               ).reshape(b, t, N_BRANCHES, D_MODEL)
        a_out = _pool_mixer(hist[l], u_pool, start_pos, pool_w[l], pool_scale[l])
        y_ssm, s_re_last, s_im_last = _s5_mixer(u_ssm, st_re[l], st_im[l], ssm_a_re[l], ssm_a_im[l],
                                                ssm_log_dt[l], ssm_b_re[l], ssm_b_im[l],
                                                ssm_c_re[l], ssm_c_im[l], ssm_d[l])
        z = jax.nn.gelu(y_ssm)
        b_out = (z * jax.nn.sigmoid(jnp.einsum('btc,ce->bte', z, glu_w[l].astype(jnp.float32))
                                    + glu_b[l].astype(jnp.float32))).astype(x.dtype)
        merged = (gates[:, :, 0] * jnp.einsum('btc,cd->btd', a_out, w_branch_pool[l]).astype(jnp.float32)
                  + gates[:, :, 1] * jnp.einsum('btc,cd->btd', b_out, w_branch_ssm[l]).astype(jnp.float32))
        h = h + jnp.einsum('btd,de->bte', merged.astype(x.dtype), w_out[l]).astype(h.dtype)
        hn = _rmsnorm(h, norm_ffn[l])
        f = jax.nn.silu(jnp.einsum('btd,df->btf', hn, ffn_w_gate[l])) * jnp.einsum('btd,df->btf', hn, ffn_w_up[l])
        h = h + jnp.einsum('btf,fd->btd', f, ffn_w_down[l]).astype(h.dtype)
        ext = jnp.concatenate([hist[l].astype(u_pool.dtype), u_pool], axis=1)
        new_hist.append(ext[:, -POOL_HIST:])
        new_re.append(s_re_last)
        new_im.append(s_im_last)
    y = _rmsnorm(h, norm_final)
    return y, jnp.stack(new_hist), jnp.stack(new_re), jnp.stack(new_im)


def setup_inputs(seed: int = 0) -> dict:
    key = jax.random.key(seed)
    ks = jax.random.split(key, 32)
    f32 = jnp.float32
    nrm = lambda k, shape, s: jax.random.normal(k, shape, f32) * s
    L = DEPTH
    a_re = -0.5 + nrm(ks[7], (L, SSM_GROUPS, SSM_STATE), 0.01)
    a_im = math.pi * jnp.arange(SSM_STATE, dtype=f32)[None, None, :] + nrm(ks[8], (L, SSM_GROUPS, SSM_STATE), 0.01)
    log_dt = jax.random.uniform(ks[9], (L, SSM_GROUPS), f32, math.log(DT_MIN), math.log(DT_MAX))
    return {
        'x_prompt': nrm(ks[0], (BATCH, SEQ, D_MODEL), 1.0),
        'x_sample': nrm(ks[1], (DEC_BATCH, DEC_SEQ, D_MODEL), 1.0),
        'state_pool': nrm(ks[2], (L, DEC_BATCH, POOL_HIST, POOL_WIDTH), 1.0),
        'state_ssm_re': nrm(ks[3], (L, DEC_BATCH, SSM_GROUPS, SSM_STATE), 0.5),
        'state_ssm_im': nrm(ks[4], (L, DEC_BATCH, SSM_GROUPS, SSM_STATE), 0.5),
        'norm_mix': 1.0 + nrm(ks[5], (L, D_MODEL), 0.02),
        'w_in': nrm(ks[6], (L, D_MODEL, IN_WIDTH), D_MODEL ** -0.5),
        'pool_w': nrm(ks[10], (L, POOL_GROUPS, POOL_GROUP_DIM, POOL_GROUP_DIM), POOL_GROUP_DIM ** -0.5),
        'pool_scale': 1.0 + nrm(ks[11], (L, POOL_WIDTH), 0.1),
        'ssm_a_re': a_re,
        'ssm_a_im': a_im,
        'ssm_log_dt': log_dt,
        'ssm_b_re': nrm(ks[12], (L, SSM_GROUPS, SSM_STATE, SSM_GROUP_DIM), (2 * SSM_GROUP_DIM) ** -0.5),
        'ssm_b_im': nrm(ks[13], (L, SSM_GROUPS, SSM_STATE, SSM_GROUP_DIM), (2 * SSM_GROUP_DIM) ** -0.5),
        'ssm_c_re': nrm(ks[14], (L, SSM_GROUPS, SSM_GROUP_DIM, SSM_STATE), (2 * SSM_STATE) ** -0.5),
        'ssm_c_im': nrm(ks[15], (L, SSM_GROUPS, SSM_GROUP_DIM, SSM_STATE), (2 * SSM_STATE) ** -0.5),
        'ssm_d': nrm(ks[16], (L, SSM_WIDTH), 1.0),
        'glu_w': nrm(ks[17], (L, SSM_WIDTH, SSM_WIDTH), SSM_WIDTH ** -0.5),
        'glu_b': nrm(ks[18], (L, SSM_WIDTH), 0.01),
        'w_branch_pool': nrm(ks[19], (L, POOL_WIDTH, D_MODEL), POOL_WIDTH ** -0.5),
        'w_branch_ssm': nrm(ks[20], (L, SSM_WIDTH, D_MODEL), SSM_WIDTH ** -0.5),
        'w_out': nrm(ks[21], (L, D_MODEL, D_MODEL), D_MODEL ** -0.5),
        'norm_ffn': 1.0 + nrm(ks[22], (L, D_MODEL), 0.02),
        'ffn_w_gate': nrm(ks[23], (L, D_MODEL, D_FF), D_MODEL ** -0.5),
        'ffn_w_up': nrm(ks[24], (L, D_MODEL, D_FF), D_MODEL ** -0.5),
        'ffn_w_down': nrm(ks[25], (L, D_FF, D_MODEL), D_FF ** -0.5),
        'norm_final': 1.0 + nrm(ks[26], (D_MODEL,), 0.02),
    }


def reference(x_prompt, x_sample, state_pool, state_ssm_re, state_ssm_im,
              norm_mix, w_in, pool_w, pool_scale, ssm_a_re, ssm_a_im, ssm_log_dt,
              ssm_b_re, ssm_b_im, ssm_c_re, ssm_c_im, ssm_d, glu_w, glu_b,
              w_branch_pool, w_branch_ssm, w_out, norm_ffn, ffn_w_gate, ffn_w_up,
              ffn_w_down, norm_final):
    bp = x_prompt.shape[0]
    zero_hist = jnp.zeros((DEPTH, bp, POOL_HIST, POOL_WIDTH), x_prompt.dtype)
    zero_ssm = jnp.zeros((DEPTH, bp, SSM_GROUPS, SSM_STATE), jnp.float32)
    y_prompt, pool_p, re_p, im_p = _trunk(
        x_prompt, zero_hist, zero_ssm, zero_ssm, 0,
        norm_mix, w_in, pool_w, pool_scale, ssm_a_re, ssm_a_im, ssm_log_dt,
        ssm_b_re, ssm_b_im, ssm_c_re, ssm_c_im, ssm_d, glu_w, glu_b,
        w_branch_pool, w_branch_ssm, w_out, norm_ffn, ffn_w_gate, ffn_w_up,
        ffn_w_down, norm_final)
    y_sample, pool_s, re_s, im_s = _trunk(
        x_sample, state_pool, state_ssm_re, state_ssm_im, PAST_LEN,
        norm_mix, w_in, pool_w, pool_scale, ssm_a_re, ssm_a_im, ssm_log_dt,
        ssm_b_re, ssm_b_im, ssm_c_re, ssm_c_im, ssm_d, glu_w, glu_b,
        w_branch_pool, w_branch_ssm, w_out, norm_ffn, ffn_w_gate, ffn_w_up,
        ffn_w_down, norm_final)
    return (y_prompt, y_sample, pool_p, re_p, im_p, pool_s, re_s, im_s)
```

```cpp
#include <hip/hip_runtime.h>
#include <cstdio>
#include <cstdint>

#ifndef MK_N_LAUNCHES
#define MK_N_LAUNCHES 9
#endif

#define GAS __attribute__((address_space(1)))
#define LAS __attribute__((address_space(3)))
typedef unsigned short bf16_t;
typedef short bf16x8 __attribute__((ext_vector_type(8)));
typedef float f32x2 __attribute__((ext_vector_type(2)));
typedef float f32x4 __attribute__((ext_vector_type(4)));
typedef float f32x16 __attribute__((ext_vector_type(16)));
typedef unsigned u32x2 __attribute__((ext_vector_type(2)));
typedef unsigned u32x4 __attribute__((ext_vector_type(4)));

constexpr int D = 1024, MP = 16384, MS = 512, MT = MP + MS, TP = 2048;
constexpr int NGRP = 32, NST = 64, DFF = 2816, INW = 3072;
constexpr float RMS_EPS = 1e-6f;
constexpr size_t O_Y = 0, O_POOLP = (size_t)MT * D, O_REP = O_POOLP + 8 * 15 * 512, O_IMP = O_REP + 8 * 32 * 64, O_POOLS = O_IMP + 8 * 32 * 64,
                 O_RES = O_POOLS + 128 * 15 * 512, O_IMS = O_RES + 128 * 32 * 64, O_END = O_IMS + 128 * 32 * 64;
static_assert(O_END == 18903040, "output size");

constexpr size_t MiB = 1u << 20;
constexpr size_t WS_CTL = 0, CTL_ZERO_BYTES = 1 * MiB;
constexpr size_t WS_SSQ2 = 256 * 1024, WS_SSQ3 = 512 * 1024;
constexpr size_t WS_TAB = 1 * MiB;
constexpr size_t WS_WIN = 2 * MiB, WS_WGLU = 8 * MiB, WS_WBR = 9 * MiB, WS_WOUT = 11 * MiB, WS_WGU = 13 * MiB, WS_WD = 24 * MiB, WS_PWT = 30 * MiB, WS_S5M = 31 * MiB;
constexpr size_t WS_XB = 42 * MiB, WS_MERGED = 42 * MiB, WS_F = 42 * MiB, WS_GATES = 76 * MiB, WS_UPOOL = 142 * MiB, WS_USSM = WS_UPOOL + (size_t)MT * 512 * 2,
                 WS_HB = 142 * MiB, WS_AB = 175 * MiB, WS_Z = 208 * MiB, WS_END = WS_Z + (size_t)MT * 512 * 2;
static_assert(WS_USSM + (size_t)MT * 512 * 2 <= WS_AB && WS_F + (size_t)MT * DFF * 2 <= WS_UPOOL && WS_XB + (size_t)MT * D * 2 <= WS_GATES && WS_GATES + (size_t)MT * 2048 * 2 <= WS_UPOOL &&
              WS_AB + (size_t)MT * D * 2 <= WS_Z && WS_END <= 256 * MiB && WS_WD + (size_t)D * DFF * 2 <= WS_PWT && WS_S5M + 32 * 262144 <= WS_XB, "d_ws map");
constexpr int CW_TMO = 0, CW_BAR = 4096;

constexpr int LDS_SCRATCH = 147456;
constexpr int MISC_OFF = LDS_SCRATCH;
constexpr int LDS_BYTES = LDS_SCRATCH + 256;
constexpr int NWAVES = 8;

#define RLX_AGENT __ATOMIC_RELAXED, __HIP_MEMORY_SCOPE_AGENT
#define LDS_WAIT() asm volatile("s_waitcnt lgkmcnt(0)" ::: "memory")
#define VM_WAIT() asm volatile("s_waitcnt vmcnt(0)" ::: "memory")

__device__ __forceinline__ unsigned f2bf(float f) { unsigned u = __builtin_bit_cast(unsigned, f); return (u + 0x7fffu + ((u >> 16) & 1u)) >> 16; }
__device__ __forceinline__ unsigned pk2(float lo, float hi) { return f2bf(lo) | (f2bf(hi) << 16); }
__device__ __forceinline__ float bflo(unsigned w) { return __builtin_bit_cast(float, w << 16); }
__device__ __forceinline__ float bfhi(unsigned w) { return __builtin_bit_cast(float, w & 0xffff0000u); }
__device__ __forceinline__ float bf1(bf16_t v) { return __builtin_bit_cast(float, (unsigned)v << 16); }
__device__ __forceinline__ unsigned cvt_pk_bf16(float lo, float hi) { unsigned r; asm volatile("v_cvt_pk_bf16_f32 %0, %1, %2" : "=v"(r) : "v"(lo), "v"(hi)); return r; }
__device__ __forceinline__ float sigmoidf_(float v) { return __builtin_amdgcn_rcpf(1.0f + __expf(-v)); }
__device__ __forceinline__ float gelu_tanh(float x) {
    const float u = 0.7978845608028654f * (x + 0.044715f * x * x * x);
    const float t = 1.0f - 2.0f * __builtin_amdgcn_rcpf(1.0f + __expf(2.0f * u));
    return 0.5f * x * (1.0f + t);
}

namespace pg8 {
constexpr int BM = 256, BK = 64, HALF = 128, HTB = HALF * BK * 2, STAGE_BYTES = 8 * HTB, NXCD = 8, WGM = 8;
__host__ __device__ __forceinline__ int lds_byte(int r, int c) { const int st = (r >> 4) * 2 + (c >> 5), rr = r & 15, cc = c & 31, ob = rr * 64 + cc * 2; return st * 1024 + (ob ^ (((ob >> 9) & 1) << 5)); }
__host__ __device__ __forceinline__ void stage_rc(int b, int& R, int& C) { const int st = b / 1024, sb = b % 1024, swz = sb ^ (((sb >> 9) & 1) << 5); R = (st >> 1) * 16 + swz / 64; C = (st & 1) * 32 + (swz % 64) / 2; }
__host__ __device__ __forceinline__ int perm32(int rho) { const int n = rho >> 4, i = rho & 15; return 8 * (i >> 2) + 4 * n + (i & 3); }

struct Unit { int pm, pn; };
struct Gemm { const bf16_t* A; const bf16_t* Bt; int M, N, K; };

struct StaticOrder {
    int nM, nN, nwg, G, c;
    __host__ __device__ void init(int M, int N, int G_, int c_) { nM = M / BM; nN = N / BM; nwg = nM * nN; G = G_; c = c_; }
    __host__ __device__ bool next(int i, Unit& u) const {
        const long L = (long)i * G + c; if (L >= nwg) return false;
        int wgid = (int)L; { const int q = nwg / NXCD, r = nwg % NXCD, xcd = wgid % NXCD, off = wgid / NXCD; wgid = (xcd < r ? xcd * (q + 1) : r * (q + 1) + (xcd - r) * q) + off; }
        const int nig = WGM * nN, gid = wgid / nig, fm = gid * WGM, gsz = (nM - fm) < WGM ? (nM - fm) : WGM;
        u.pm = fm + ((wgid % nig) % gsz); u.pn = (wgid % nig) / gsz; return true;
    }
    __device__ __forceinline__ void a_ready(const Unit&) const {}
    __device__ __forceinline__ void done(const Unit&) const {}
};

template <class Epi, class Sched, bool ALIGN_EPI, bool SP2, bool AGM>
__device__ __forceinline__ void gemm_phase(LAS unsigned char* lds, const Gemm g, const Sched& S, const Epi& E) {
    const int tid = threadIdx.x, wid = __builtin_amdgcn_readfirstlane(tid >> 6), lane = tid & 63, wr = wid >> 2, wc = wid & 3, fr = lane & 15, fq = lane >> 4;
    const int K = g.K, nt = K / BK;
    constexpr size_t GS = (size_t)MT * 32;
    unsigned voffA[2], voffB[2];
#pragma unroll
    for (int i = 0; i < 2; ++i) { int R, C; stage_rc(tid * 16 + i * 8192, R, C); const int Rb = Epi::PERM ? ((R & ~31) + perm32(R & 31)) : R;
        voffA[i] = AGM ? (unsigned)((size_t)(C >> 4) * GS + (size_t)R * 32 + (size_t)(C & 15) * 2) : (unsigned)(R * K + C) * 2u; voffB[i] = (unsigned)(Rb * K + C) * 2u; }
    const size_t kstepB = (size_t)(BK * 2), hstepB = (size_t)HALF * K * 2, tstepB = 2 * hstepB;
    const size_t kstepA = AGM ? 4 * GS : kstepB, hstepA = AGM ? (size_t)HALF * 32 : hstepB, tstepA = 2 * hstepA;
    const unsigned ldsw = (unsigned)wid * 1024u;
    const int aoff = lds_byte(wr * 64 + fr, fq * 8), boff = lds_byte(wc * 32 + fr, fq * 8);
#define PG8_SA(b, h) (((b) * 2 + (h)) * HTB)
#define PG8_SB(b, h) ((4 + (b) * 2 + (h)) * HTB)
#define PG8_STAGE(bufoff, gbase, voff) do { _Pragma("unroll") for (int _i = 0; _i < 2; ++_i) \
        __builtin_amdgcn_global_load_lds((const unsigned*)((const char*)(gbase) + (voff)[_i]), (LAS unsigned*)(lds + (bufoff) + ldsw + _i * 8192), 16, 0, 0); } while (0)
#define PG8_LDA(dst, b, h) do { _Pragma("unroll") for (int m = 0; m < 4; ++m) _Pragma("unroll") for (int k = 0; k < 2; ++k) dst[m][k] = *(const LAS bf16x8*)(lds + PG8_SA(b, h) + aoff + m * 2048 + k * 1024); } while (0)
#define PG8_LDB(dst, b, h) do { _Pragma("unroll") for (int n = 0; n < 2; ++n) _Pragma("unroll") for (int k = 0; k < 2; ++k) dst[n][k] = *(const LAS bf16x8*)(lds + PG8_SB(b, h) + boff + n * 2048 + k * 1024); } while (0)
#define PG8_MMA(ai, bj, At, Bt) do { __builtin_amdgcn_s_setprio(1); _Pragma("unroll") for (int m = 0; m < 4; ++m) _Pragma("unroll") for (int n = 0; n < 2; ++n) _Pragma("unroll") for (int k = 0; k < 2; ++k) \
        acc[ai][bj][m][n] = __builtin_amdgcn_mfma_f32_16x16x32_bf16(Bt[n][k], At[m][k], acc[ai][bj][m][n], 0, 0, 0); __builtin_amdgcn_s_setprio(0); } while (0)
#define PG8_WAIT_V(n) asm volatile("s_waitcnt vmcnt(" #n ")" ::: "memory")
#define PG8_WAIT_L(n) asm volatile("s_waitcnt lgkmcnt(" #n ")" ::: "memory")
#define PG8_BAR __builtin_amdgcn_s_barrier()
#define PG8_SCHED __builtin_amdgcn_sched_barrier(0)
    Unit cur, nxt; int ui = 0;
    if (!S.next(0, cur)) return;
    f32x4 acc[2][2][4][2];
#pragma unroll
    for (int a = 0; a < 2; ++a)
#pragma unroll
        for (int b = 0; b < 2; ++b)
#pragma unroll
            for (int m = 0; m < 4; ++m)
#pragma unroll
                for (int n = 0; n < 2; ++n) acc[a][b][m][n] = (f32x4){0.f, 0.f, 0.f, 0.f};
    bf16x8 At[4][2], B0[2][2], B1[2][2];
    const char* cA = (const char*)g.A + (size_t)cur.pm * tstepA; const char* cB = (const char*)g.Bt + (size_t)cur.pn * tstepB;
    S.a_ready(cur);
    if constexpr (SP2) {
        PG8_STAGE(PG8_SB(0, 0), cB, voffB); PG8_STAGE(PG8_SB(0, 1), cB + hstepB, voffB); PG8_STAGE(PG8_SA(0, 0), cA, voffA); PG8_STAGE(PG8_SA(0, 1), cA + hstepA, voffA);
        if (wr == 1) PG8_BAR;
        PG8_WAIT_V(2); PG8_BAR;
        PG8_STAGE(PG8_SB(1, 0), cB + kstepB, voffB); PG8_STAGE(PG8_SA(1, 0), cA + kstepA, voffA); PG8_STAGE(PG8_SB(1, 1), cB + hstepB + kstepB, voffB);
        PG8_WAIT_V(6); PG8_BAR;
    } else {
        PG8_STAGE(PG8_SB(0, 0), cB, voffB); PG8_STAGE(PG8_SA(0, 0), cA, voffA); PG8_STAGE(PG8_SB(0, 1), cB + hstepB, voffB); PG8_STAGE(PG8_SA(0, 1), cA + hstepA, voffA);
        if (wr == 1) PG8_BAR;
        PG8_WAIT_V(4); PG8_BAR;
        PG8_STAGE(PG8_SB(1, 0), cB + kstepB, voffB); PG8_STAGE(PG8_SA(1, 0), cA + kstepA, voffA); PG8_STAGE(PG8_SB(1, 1), cB + hstepB + kstepB, voffB);
        PG8_WAIT_V(6); PG8_BAR;
    }
    for (;;) {
        const bool has_next = S.next(ui + 1, nxt);
        const char* nA = has_next ? (const char*)g.A + (size_t)nxt.pm * tstepA : cA; const char* nB = has_next ? (const char*)g.Bt + (size_t)nxt.pn * tstepB : cB;
        for (int t = 0; t < nt; t += 2) {
            const bool last = (t == nt - 2);
            const char* a1 = cA + (size_t)(t + 1) * kstepA;
            const char* a2 = last ? nA : cA + (size_t)(t + 2) * kstepA; const char* b2 = last ? nB : cB + (size_t)(t + 2) * kstepB;
            const char* a3 = a2 + kstepA; const char* b3 = b2 + kstepB;
            if (last && has_next) S.a_ready(nxt);
            if constexpr (Epi::MID) { if (t == (nt >> 1)) E.mid(acc, cur, wr, wc, fr, fq); }
            if constexpr (SP2) {
            PG8_LDB(B0, 0, 0); PG8_LDB(B1, 0, 1); PG8_SCHED; PG8_LDA(At, 0, 0); PG8_STAGE(PG8_SA(1, 1), a1 + hstepA, voffA);
            PG8_WAIT_V(8); PG8_WAIT_L(0); PG8_BAR; PG8_MMA(0, 0, At, B0); PG8_MMA(0, 1, At, B1); PG8_BAR; PG8_SCHED;
            PG8_LDA(At, 0, 1); PG8_STAGE(PG8_SB(0, 0), b2, voffB); PG8_STAGE(PG8_SB(0, 1), b2 + hstepB, voffB); PG8_STAGE(PG8_SA(0, 0), a2, voffA);
            PG8_WAIT_V(8); PG8_WAIT_L(0); PG8_BAR; PG8_MMA(1, 0, At, B0); PG8_MMA(1, 1, At, B1); PG8_BAR; PG8_SCHED;
            PG8_LDB(B0, 1, 0); PG8_LDB(B1, 1, 1); PG8_SCHED; PG8_LDA(At, 1, 0); PG8_STAGE(PG8_SA(0, 1), a2 + hstepA, voffA);
            PG8_WAIT_V(8); PG8_WAIT_L(0); PG8_BAR; PG8_MMA(0, 0, At, B0); PG8_MMA(0, 1, At, B1); PG8_BAR; PG8_SCHED;
            PG8_LDA(At, 1, 1); PG8_STAGE(PG8_SB(1, 0), b3, voffB); PG8_STAGE(PG8_SB(1, 1), b3 + hstepB, voffB); PG8_STAGE(PG8_SA(1, 0), a3, voffA);
            PG8_WAIT_V(8); PG8_WAIT_L(0); PG8_BAR; PG8_MMA(1, 0, At, B0); PG8_MMA(1, 1, At, B1); PG8_BAR; PG8_SCHED;
            } else {
            PG8_LDB(B0, 0, 0); PG8_SCHED; PG8_LDA(At, 0, 0); PG8_STAGE(PG8_SA(1, 1), a1 + hstepA, voffA);
            PG8_WAIT_L(8); PG8_BAR; PG8_WAIT_L(0); PG8_MMA(0, 0, At, B0); PG8_BAR; PG8_SCHED;
            PG8_LDB(B1, 0, 1); PG8_STAGE(PG8_SB(0, 0), b2, voffB);
            PG8_BAR; PG8_WAIT_L(0); PG8_MMA(0, 1, At, B1); PG8_BAR;
            PG8_LDA(At, 0, 1); PG8_STAGE(PG8_SA(0, 0), a2, voffA);
            PG8_BAR; PG8_WAIT_L(0); PG8_MMA(1, 0, At, B0); PG8_BAR; PG8_SCHED;
            PG8_STAGE(PG8_SB(0, 1), b2 + hstepB, voffB);
            PG8_WAIT_V(6); PG8_BAR; PG8_MMA(1, 1, At, B1); PG8_BAR;
            PG8_LDB(B0, 1, 0); PG8_SCHED; PG8_LDA(At, 1, 0); PG8_STAGE(PG8_SA(0, 1), a2 + hstepA, voffA);
            PG8_WAIT_L(8); PG8_BAR; PG8_WAIT_L(0); PG8_MMA(0, 0, At, B0); PG8_BAR; PG8_SCHED;
            PG8_LDB(B1, 1, 1); PG8_STAGE(PG8_SB(1, 0), b3, voffB);
            PG8_BAR; PG8_WAIT_L(0); PG8_MMA(0, 1, At, B1); PG8_BAR;
            PG8_LDA(At, 1, 1); PG8_STAGE(PG8_SA(1, 0), a3, voffA);
            PG8_BAR; PG8_WAIT_L(0); PG8_MMA(1, 0, At, B0); PG8_BAR; PG8_SCHED;
            PG8_STAGE(PG8_SB(1, 1), b3 + hstepB, voffB);
            PG8_WAIT_V(6); PG8_BAR; PG8_MMA(1, 1, At, B1); PG8_BAR;
            }
        }
        if constexpr (ALIGN_EPI) { if (wr == 0) PG8_BAR; }
        E(acc, cur, wr, wc, fr, fq); S.done(cur);
        if (!has_next) break;
#pragma unroll
        for (int a = 0; a < 2; ++a)
#pragma unroll
            for (int b = 0; b < 2; ++b)
#pragma unroll
                for (int m = 0; m < 4; ++m)
#pragma unroll
                    for (int n = 0; n < 2; ++n) acc[a][b][m][n] = (f32x4){0.f, 0.f, 0.f, 0.f};
        cur = nxt; cA = nA; cB = nB; ++ui;
        if constexpr (ALIGN_EPI) { if (wr == 1) PG8_BAR; }
    }
    PG8_WAIT_V(0);
    if constexpr (!ALIGN_EPI) { if (wr == 0) PG8_BAR; }
    PG8_BAR;
#undef PG8_SA
#undef PG8_SB
#undef PG8_STAGE
#undef PG8_LDA
#undef PG8_LDB
#undef PG8_MMA
#undef PG8_WAIT_V
#undef PG8_WAIT_L
#undef PG8_BAR
#undef PG8_SCHED
}

typedef f32x4 AccT[2][2][4][2];
__device__ __forceinline__ u32x4 pack8(const f32x4 v0, const f32x4 v1) { u32x4 w; w.x = cvt_pk_bf16(v0[0], v0[1]); w.y = cvt_pk_bf16(v0[2], v0[3]); w.z = cvt_pk_bf16(v1[0], v1[1]); w.w = cvt_pk_bf16(v1[2], v1[3]); return w; }
__device__ __forceinline__ void unpack8(const u32x4 w, f32x4& v0, f32x4& v1) { v0 = (f32x4){bflo(w.x), bfhi(w.x), bflo(w.y), bfhi(w.y)}; v1 = (f32x4){bflo(w.z), bfhi(w.z), bflo(w.w), bfhi(w.w)}; }

struct EpiIn {
    static constexpr bool PERM = true, MID = false;
    bf16_t* upool; bf16_t* ussm; bf16_t* gates;
    __device__ __forceinline__ void operator()(const AccT& acc, const Unit& u, int wr, int wc, int fr, int fq) const {
        const int row0 = u.pm * BM + wr * 64 + fr, colb = u.pn * BM + wc * 32 + 8 * fq;
#pragma unroll
        for (int ai = 0; ai < 2; ++ai)
#pragma unroll
            for (int m = 0; m < 4; ++m) { const int row = row0 + ai * HALF + m * 16;
#pragma unroll
                for (int bj = 0; bj < 2; ++bj) { const int col = colb + bj * HALF; f32x4 v0 = acc[ai][bj][m][0], v1 = acc[ai][bj][m][1];
                    if (u.pn < 2) { *(u32x4*)(upool + (size_t)row * 512 + col) = pack8(v0, v1); }
                    else if (u.pn < 4) { const int c = col - 512; *(u32x4*)(ussm + ((size_t)(c >> 4) * MT + row) * 16 + (c & 15)) = pack8(v0, v1); }
                    else {
#pragma unroll
                        for (int j = 0; j < 4; ++j) { v0[j] = sigmoidf_(v0[j]); v1[j] = sigmoidf_(v1[j]); }
                        *(u32x4*)(gates + (size_t)row * 2048 + (col - 1024)) = pack8(v0, v1); } } }
    }
};
struct EpiGlu {
    static constexpr bool PERM = true, MID = false;
    const bf16_t* z; const float* glu_b; bf16_t* ab;
    __device__ __forceinline__ void operator()(const AccT& acc, const Unit& u, int wr, int wc, int fr, int fq) const {
        const int row0 = u.pm * BM + wr * 64 + fr, colb = u.pn * BM + wc * 32 + 8 * fq;
        f32x4 bv[2][2];
#pragma unroll
        for (int bj = 0; bj < 2; ++bj) { bv[bj][0] = *(const f32x4*)(glu_b + colb + bj * HALF); bv[bj][1] = *(const f32x4*)(glu_b + colb + bj * HALF + 4); }
#pragma unroll
        for (int ai = 0; ai < 2; ++ai)
#pragma unroll
            for (int m = 0; m < 4; ++m) { const int row = row0 + ai * HALF + m * 16;
#pragma unroll
                for (int bj = 0; bj < 2; ++bj) { const int col = colb + bj * HALF;
                    const u32x4 zw = *(const u32x4*)(z + ((size_t)(col >> 4) * MT + row) * 16 + (col & 15)); f32x4 z0, z1; unpack8(zw, z0, z1);
                    f32x4 v0 = acc[ai][bj][m][0] + bv[bj][0], v1 = acc[ai][bj][m][1] + bv[bj][1];
#pragma unroll
                    for (int j = 0; j < 4; ++j) { v0[j] = z0[j] * sigmoidf_(v0[j]); v1[j] = z1[j] * sigmoidf_(v1[j]); }
                    *(u32x4*)(ab + (size_t)row * 1024 + 512 + col) = pack8(v0, v1); } }
    }
};
struct EpiBr {
    static constexpr bool PERM = true, MID = true;
    const bf16_t* gates; bf16_t* merged;
    static constexpr float TINY = 8.673617379884035e-19f;
    __device__ __forceinline__ void mid(AccT& acc, const Unit& u, int wr, int wc, int fr, int fq) const {
        const int row0 = u.pm * BM + wr * 64 + fr, colb = u.pn * BM + wc * 32 + 8 * fq;
        const bf16_t* gp = gates + (size_t)row0 * 2048 + colb;
        asm volatile("" : "+v"(gp));
#pragma unroll
        for (int ai = 0; ai < 2; ++ai)
#pragma unroll
            for (int m = 0; m < 4; ++m) {
#pragma unroll
                for (int bj = 0; bj < 2; ++bj) { const bf16_t* q = gp + (size_t)(ai * HALF + m * 16) * 2048 + bj * HALF;
                    const u32x4 w0 = *(const u32x4*)q, w1 = *(const u32x4*)(q + 1024);
                    f32x4 a0, a1, b0, b1; unpack8(w0, a0, a1); unpack8(w1, b0, b1);
#pragma unroll
                    for (int j = 0; j < 4; ++j) { acc[ai][bj][m][0][j] *= a0[j] * __builtin_amdgcn_rcpf(fmaxf(b0[j], TINY)); acc[ai][bj][m][1][j] *= a1[j] * __builtin_amdgcn_rcpf(fmaxf(b1[j], TINY)); } } }
    }
    __device__ __forceinline__ void operator()(const AccT& acc, const Unit& u, int wr, int wc, int fr, int fq) const {
        const int row0 = u.pm * BM + wr * 64 + fr, colb = u.pn * BM + wc * 32 + 8 * fq;
#pragma unroll
        for (int ai = 0; ai < 2; ++ai)
#pragma unroll
            for (int m = 0; m < 4; ++m) { const int row = row0 + ai * HALF + m * 16;
#pragma unroll
                for (int bj = 0; bj < 2; ++bj) { const int col = colb + bj * HALF;
                    const u32x4 w1 = *(const u32x4*)(gates + (size_t)row * 2048 + 1024 + col); f32x4 b0, b1; unpack8(w1, b0, b1);
                    f32x4 v0 = acc[ai][bj][m][0], v1 = acc[ai][bj][m][1];
#pragma unroll
                    for (int j = 0; j < 4; ++j) { v0[j] *= fmaxf(b0[j], TINY); v1[j] *= fmaxf(b1[j], TINY); }
                    *(u32x4*)(merged + (size_t)row * 1024 + col) = pack8(v0, v1); } }
    }
};
struct EpiOut {
    static constexpr bool PERM = true, MID = false;
    const float* xp; const float* xs; float* h; bf16_t* hb; float* ssq;
    __device__ __forceinline__ void operator()(const AccT& acc, const Unit& u, int wr, int wc, int fr, int fq) const {
        const int row0 = u.pm * BM + wr * 64 + fr, colb = u.pn * BM + wc * 32 + 8 * fq;
        const float* xb = (u.pm < MP / BM) ? xp : xs - (size_t)MP * D;
#pragma unroll
        for (int ai = 0; ai < 2; ++ai)
#pragma unroll
            for (int m = 0; m < 4; ++m) { const int row = row0 + ai * HALF + m * 16; float ss = 0.f;
#pragma unroll
                for (int bj = 0; bj < 2; ++bj) { const size_t o = (size_t)row * D + colb + bj * HALF;
                    const f32x4 v0 = acc[ai][bj][m][0] + *(const f32x4*)(xb + o), v1 = acc[ai][bj][m][1] + *(const f32x4*)(xb + o + 4);
                    *(f32x4*)(h + o) = v0; *(f32x4*)(h + o + 4) = v1; *(u32x4*)(hb + o) = pack8(v0, v1);
                    ss += (v0[0] * v0[0] + v0[1] * v0[1]) + (v0[2] * v0[2] + v0[3] * v0[3]) + (v1[0] * v1[0] + v1[1] * v1[1]) + (v1[2] * v1[2] + v1[3] * v1[3]); }
                ss += __shfl_xor(ss, 16); ss += __shfl_xor(ss, 32);
                if (fq == 0) atomicAdd(ssq + row, ss); }
    }
};
struct EpiUp {
    static constexpr bool PERM = true, MID = false;
    const float* ssq; bf16_t* f;
    __device__ __forceinline__ void operator()(const AccT& acc, const Unit& u, int wr, int wc, int fr, int fq) const {
        const int row0 = u.pm * BM + wr * 64 + fr, colf = u.pn * HALF + wc * 32 + 8 * fq;
#pragma unroll
        for (int ai = 0; ai < 2; ++ai)
#pragma unroll
            for (int m = 0; m < 4; ++m) { const int row = row0 + ai * HALF + m * 16;
                const float r = __builtin_amdgcn_rsqf(ssq[row] * (1.0f / D) + RMS_EPS);
                f32x4 o[2];
#pragma unroll
                for (int n = 0; n < 2; ++n)
#pragma unroll
                    for (int j = 0; j < 4; ++j) { const float gv = acc[ai][0][m][n][j] * r, uv = acc[ai][1][m][n][j] * r; o[n][j] = gv * sigmoidf_(gv) * uv; }
                *(u32x4*)(f + (size_t)row * DFF + colf) = pack8(o[0], o[1]); }
    }
};
struct EpiDown {
    static constexpr bool PERM = true, MID = false;
    float* h; float* ssq;
    __device__ __forceinline__ void operator()(const AccT& acc, const Unit& u, int wr, int wc, int fr, int fq) const {
        const int row0 = u.pm * BM + wr * 64 + fr, colb = u.pn * BM + wc * 32 + 8 * fq;
#pragma unroll
        for (int ai = 0; ai < 2; ++ai)
#pragma unroll
            for (int m = 0; m < 4; ++m) { const int row = row0 + ai * HALF + m * 16; float ss = 0.f;
#pragma unroll
                for (int bj = 0; bj < 2; ++bj) { const size_t o = (size_t)row * D + colb + bj * HALF;
                    const f32x4 v0 = acc[ai][bj][m][0] + *(const f32x4*)(h + o), v1 = acc[ai][bj][m][1] + *(const f32x4*)(h + o + 4);
                    *(f32x4*)(h + o) = v0; *(f32x4*)(h + o + 4) = v1;
                    ss += (v0[0] * v0[0] + v0[1] * v0[1]) + (v0[2] * v0[2] + v0[3] * v0[3]) + (v1[0] * v1[0] + v1[1] * v1[1]) + (v1[2] * v1[2] + v1[3] * v1[3]); }
                ss += __shfl_xor(ss, 16); ss += __shfl_xor(ss, 32);
                if (fq == 0) atomicAdd(ssq + row, ss); }
    }
};
}

#define XB_TMO      128
#define XB_XCNT(j)  (256  + 64 * (j))
#define XB_XSUB(j)  (1280 + 64 * (j))
#define XB_XGEN(j)  (2304 + 64 * (j))
#define XB_TOP      3328
#define XB_TOPGEN   3392
#define XCD_BAR_WORDS 3456
#define XB_SPIN_CAP (1u << 18)
__device__ __forceinline__ unsigned xb_ld(unsigned* p)              { return __hip_atomic_load(p, __ATOMIC_RELAXED, __HIP_MEMORY_SCOPE_AGENT); }
__device__ __forceinline__ unsigned xb_add(unsigned* p, unsigned v) { return __hip_atomic_fetch_add(p, v, __ATOMIC_RELAXED, __HIP_MEMORY_SCOPE_AGENT); }
__device__ __forceinline__ unsigned xb_xcc_id() { return (unsigned)__builtin_amdgcn_s_getreg((3 << 11) | 20) & 0xFu; }
#define XB_SPIN(cond, bar) do { unsigned _sp = 0; while (cond) { __builtin_amdgcn_s_sleep(1); \
    if ((++_sp & 255u) == 0u) { if (xb_ld(&(bar)[XB_TMO])) break; if (_sp > XB_SPIN_CAP) { atomicAdd(&(bar)[XB_TMO], 1u); break; } } } } while (0)
struct XcdBarrier { unsigned* bar; unsigned x; volatile LAS unsigned* st; };
__device__ __forceinline__ XcdBarrier xcd_barrier_post(unsigned* bar, volatile LAS unsigned* st) {
    XcdBarrier b; b.bar = bar; b.x = xb_xcc_id(); b.st = st;
    if (threadIdx.x == 0) (void)xb_add(&bar[XB_XCNT(b.x)], 1u);
    return b;
}
__device__ __forceinline__ void xcd_barrier_complete(unsigned* bar, unsigned x, unsigned& nloc, unsigned& nx) {
    const unsigned G = gridDim.x * gridDim.y * gridDim.z;
    unsigned sum, cnt, mine, sp = 0u;
    for (;;) {
        sum = 0u; cnt = 0u; mine = 0u;
#pragma unroll
        for (unsigned j = 0; j < 16; ++j) { const unsigned c = xb_ld(&bar[XB_XCNT(j)]); sum += c; cnt += (c > 0u) ? 1u : 0u; mine = (j == x) ? c : mine; }
        if (sum == G) break;
        __builtin_amdgcn_s_sleep(1);
        if ((++sp & 255u) == 0u) { if (xb_ld(&bar[XB_TMO])) break; if (sp > XB_SPIN_CAP) { atomicAdd(&bar[XB_TMO], 1u); break; } }
    }
    nloc = mine > 0u ? mine : 1u; nx = cnt > 0u ? cnt : 1u;
}
__device__ __forceinline__ void xcd_barrier(const XcdBarrier& b) {
    asm volatile("s_waitcnt vmcnt(0)" ::: "memory");
    __syncthreads();
    if (threadIdx.x == 0) {
        unsigned* bar = b.bar;
        __builtin_amdgcn_s_waitcnt(0);
        unsigned nloc = b.st[0], nx = b.st[1];
        if (nloc == 0u) { xcd_barrier_complete(bar, b.x, nloc, nx); b.st[0] = nloc; b.st[1] = nx; }
        const unsigned old = xb_add(&bar[XB_XSUB(b.x)], 1u);
        const unsigned gen = old / nloc;
        if (old + 1u == (gen + 1u) * nloc) {
            __builtin_amdgcn_fence(__ATOMIC_RELEASE, "agent");
            asm volatile("s_waitcnt vmcnt(0)" ::: "memory");
            const unsigned og = xb_add(&bar[XB_TOP], 1u);
            const unsigned tg = og / nx;
            if (og + 1u == (tg + 1u) * nx) xb_add(&bar[XB_TOPGEN], 1u);
            else XB_SPIN(xb_ld(&bar[XB_TOPGEN]) == tg, bar);
            __builtin_amdgcn_fence(__ATOMIC_ACQUIRE, "agent");
            xb_add(&bar[XB_XGEN(b.x)], 1u);
            asm volatile("s_waitcnt vmcnt(0)" ::: "memory");
        } else {
            XB_SPIN(xb_ld(&bar[XB_XGEN(b.x)]) == gen, bar);
            __builtin_amdgcn_fence(__ATOMIC_ACQUIRE, "agent");
            asm volatile("s_waitcnt vmcnt(0)" ::: "memory");
        }
    }
    __syncthreads();
}

struct Args { const float* in[27]; float* out; unsigned char* ws; int ph_lo, ph_hi, li, pad; };
enum { I_XP = 0, I_XS, I_SPOOL, I_SRE, I_SIM, I_NMIX, I_WIN, I_POOLW, I_PSCALE, I_ARE, I_AIM, I_LOGDT, I_BRE, I_BIM, I_CRE, I_CIM, I_SD, I_GLUW, I_GLUB,
       I_WBP, I_WBS, I_WOUT, I_NFFN, I_WG, I_WU, I_WD, I_NFIN };

__device__ __forceinline__ float wave_sum(float v) {
#pragma unroll
    for (int o = 1; o < 64; o <<= 1) v += __shfl_xor(v, o);
    return v;
}

__device__ __forceinline__ void tr_item(const float* W, int N, int k0, int n0, const float* kscale, bf16_t* dst, int ld, LAS float* scr, int lane) {
#pragma unroll 8
    for (int i = 0; i < 32; ++i) { const int kk = 2 * i + (lane >> 5); float v = W[(size_t)(k0 + kk) * N + n0 + (lane & 31)]; if (kscale) v *= kscale[k0 + kk]; scr[kk * 33 + (lane & 31)] = v; }
    LDS_WAIT(); asm volatile("" ::: "memory");
    const int c = lane & 7;
#pragma unroll
    for (int j = 0; j < 4; ++j) { const int n = (lane >> 3) + 8 * j; const LAS float* s = scr + (8 * c) * 33 + n;
        u32x4 o; o.x = pk2(s[0 * 33], s[1 * 33]); o.y = pk2(s[2 * 33], s[3 * 33]); o.z = pk2(s[4 * 33], s[5 * 33]); o.w = pk2(s[6 * 33], s[7 * 33]);
        *(GAS u32x4*)(dst + (size_t)n * ld + 8 * c) = o; }
    LDS_WAIT(); asm volatile("" ::: "memory");
}

__device__ __forceinline__ void s5_prep(LAS unsigned char* lds, int g, const Args& a, int tid) {
    LAS f32x2* LP = (LAS f32x2*)lds;
    LAS f32x2* BC = (LAS f32x2*)(lds + 8704);
    LAS f32x2* CC = (LAS f32x2*)(lds + 16896);
    LAS float* KD = (LAS float*)(lds + 25088);
    float* tab = (float*)(a.ws + WS_TAB);
    if (tid < 64) {
        const int p = tid;
        const float dt = __expf(a.in[I_LOGDT][g]);
        const float ar = a.in[I_ARE][g * 64 + p], ai = a.in[I_AIM][g * 64 + p];
        const float zr = ar * dt, zi = ai * dt, mag = expf(zr);
        float sn, cs; sincosf(zi, &sn, &cs);
        const float lr = mag * cs, li = mag * sn;
        const float sh = sinf(0.5f * zi);
        const float nr = expm1f(zr) * cs - 2.0f * sh * sh, ni = li;
        const float den = ar * ar + ai * ai;
        const float cfr = (nr * ar + ni * ai) / den, cfi = (ni * ar - nr * ai) / den;
        float pr = 1.f, pi = 0.f; LP[p] = (f32x2){1.f, 0.f};
        for (int d = 1; d <= 16; ++d) { const float t = pr * lr - pi * li; pi = pr * li + pi * lr; pr = t; LP[d * 64 + p] = (f32x2){pr, pi}; }
        tab[(g * 64 + p) * 2] = lr; tab[(g * 64 + p) * 2 + 1] = li;
        tab[4096 + (g * 64 + p) * 2] = pr; tab[4096 + (g * 64 + p) * 2 + 1] = pi;
        for (int k = 0; k < 4; ++k) { const float t = pr * pr - pi * pi; pi = 2.f * pr * pi; pr = t; }
        tab[8192 + (g * 64 + p) * 2] = pr; tab[8192 + (g * 64 + p) * 2 + 1] = pi;
        for (int h = 0; h < 16; ++h) { const float br = a.in[I_BRE][(g * 64 + p) * 16 + h], bi = a.in[I_BIM][(g * 64 + p) * 16 + h];
            const f32x2 bc = (f32x2){cfr * br - cfi * bi, cfr * bi + cfi * br}; BC[p * 16 + h] = bc;
            tab[16384 + ((g * 64 + p) * 16 + h) * 2] = bc.x; tab[16384 + ((g * 64 + p) * 16 + h) * 2 + 1] = bc.y; }
    }
    for (int e = tid; e < 1024; e += 512) { const int hp = e >> 6, p = e & 63; CC[e] = (f32x2){a.in[I_CRE][(g * 16 + hp) * 64 + p], a.in[I_CIM][(g * 16 + hp) * 64 + p]}; }
    __syncthreads();
    for (int k = 0; k < 8; ++k) { const int e = tid + 512 * k, d = e >> 8, hp = (e >> 4) & 15, h = e & 15; float s = 0.f;
        for (int p = 0; p < 64; ++p) { const f32x2 c = CC[hp * 64 + p], l = LP[d * 64 + p], b = BC[p * 16 + h];
            const float clr = c.x * l.x - c.y * l.y, cli = c.x * l.y + c.y * l.x; s += clr * b.x - cli * b.y; }
        if (d == 0 && hp == h) s += a.in[I_SD][g * 16 + h];
        KD[e] = s; }
    __syncthreads();
    bf16_t* Mg = (bf16_t*)(a.ws + WS_S5M) + (size_t)g * 131072; bf16_t* Pg = Mg + 65536; bf16_t* Qg = Mg + 98304;
    for (int k = 0; k < 16; ++k) { const int v = tid + 512 * k, n = v >> 5, kc = 8 * (v & 31), i = kc >> 4, hb = kc & 15, j = n >> 4, hp = n & 15; float x[8];
#pragma unroll
        for (int t = 0; t < 8; ++t) x[t] = (j >= i) ? KD[((j - i) * 16 + hp) * 16 + hb + t] : 0.f;
        u32x4 o; o.x = pk2(x[0], x[1]); o.y = pk2(x[2], x[3]); o.z = pk2(x[4], x[5]); o.w = pk2(x[6], x[7]); *(GAS u32x4*)(Mg + n * 256 + kc) = o; }
    for (int k = 0; k < 8; ++k) { const int v = tid + 512 * k, n = v >> 5, p = n >> 1, ri = n & 1, kc = 8 * (v & 31), i = kc >> 4, hb = kc & 15; const f32x2 l = LP[(15 - i) * 64 + p]; float x[8];
#pragma unroll
        for (int t = 0; t < 8; ++t) { const f32x2 b = BC[p * 16 + hb + t]; x[t] = ri ? (l.x * b.y + l.y * b.x) : (l.x * b.x - l.y * b.y); }
        u32x4 o; o.x = pk2(x[0], x[1]); o.y = pk2(x[2], x[3]); o.z = pk2(x[4], x[5]); o.w = pk2(x[6], x[7]); *(GAS u32x4*)(Pg + n * 256 + kc) = o; }
    for (int k = 0; k < 8; ++k) { const int v = tid + 512 * k, n = v >> 4, j = n >> 4, hp = n & 15, kc = 8 * (v & 15); float x[8];
#pragma unroll
        for (int t = 0; t < 8; ++t) { const int p = (kc + t) >> 1; const f32x2 c = CC[hp * 64 + p], l = LP[(j + 1) * 64 + p]; x[t] = (t & 1) ? -(c.x * l.y + c.y * l.x) : (c.x * l.x - c.y * l.y); }
        u32x4 o; o.x = pk2(x[0], x[1]); o.y = pk2(x[2], x[3]); o.z = pk2(x[4], x[5]); o.w = pk2(x[6], x[7]); *(GAS u32x4*)(Qg + n * 128 + kc) = o; }
    __syncthreads();
}

__device__ __forceinline__ void p0_prologue(LAS unsigned char* lds, const Args& a, int vcu, int G, int tid, int wave, int lane) {
    if (vcu < NGRP) s5_prep(lds, vcu, a, tid);
    for (int g = vcu + G; g < NGRP; g += G) s5_prep(lds, g, a, tid);
    LAS float* scr = (LAS float*)(lds + wave * 16384);
    const int gw = vcu * NWAVES + wave, NGW = G * NWAVES;
    constexpr int I_1 = 16 * 96, I_2 = 8 * 16, I_3 = 8 * 32, I_5 = 16 * 32, I_6 = 16 * 88, I_8 = 44 * 32, I_9 = 32;
    constexpr int NITEMS = I_1 + I_2 + 2 * I_3 + I_5 + 2 * I_6 + I_8 + I_9;
    unsigned char* ws = a.ws;
    for (int it = gw; it < NITEMS; it += NGW) {
        int r = it;
        if (r < I_1) { const int kb = r / 96, nb = r % 96; tr_item(a.in[I_WIN], INW, 64 * kb, 32 * nb, a.in[I_NMIX], (bf16_t*)(ws + WS_WIN) + (size_t)(32 * nb) * D + 64 * kb, D, scr, lane); continue; } r -= I_1;
        if (r < I_2) { const int kb = r / 16, nb = r % 16; tr_item(a.in[I_GLUW], 512, 64 * kb, 32 * nb, nullptr, (bf16_t*)(ws + WS_WGLU) + (size_t)(32 * nb) * 512 + 64 * kb, 512, scr, lane); continue; } r -= I_2;
        if (r < I_3) { const int kb = r / 32, nb = r % 32; tr_item(a.in[I_WBP], D, 64 * kb, 32 * nb, nullptr, (bf16_t*)(ws + WS_WBR) + (size_t)(32 * nb) * D + 64 * kb, D, scr, lane); continue; } r -= I_3;
        if (r < I_3) { const int kb = r / 32, nb = r % 32; tr_item(a.in[I_WBS], D, 64 * kb, 32 * nb, nullptr, (bf16_t*)(ws + WS_WBR) + (size_t)(32 * nb) * D + 512 + 64 * kb, D, scr, lane); continue; } r -= I_3;
        if (r < I_5) { const int kb = r / 32, nb = r % 32; tr_item(a.in[I_WOUT], D, 64 * kb, 32 * nb, nullptr, (bf16_t*)(ws + WS_WOUT) + (size_t)(32 * nb) * D + 64 * kb, D, scr, lane); continue; } r -= I_5;
        if (r < 2 * I_6) { const int up = r >= I_6; if (up) r -= I_6; const int kb = r / 88, nb = r % 88, n0 = 32 * nb, drow = 256 * (n0 >> 7) + 128 * up + (n0 & 127);
            tr_item(a.in[up ? I_WU : I_WG], DFF, 64 * kb, n0, a.in[I_NFFN], (bf16_t*)(ws + WS_WGU) + (size_t)drow * D + 64 * kb, D, scr, lane); continue; } r -= 2 * I_6;
        if (r < I_8) { const int kb = r / 32, nb = r % 32; tr_item(a.in[I_WD], D, 64 * kb, 32 * nb, nullptr, (bf16_t*)(ws + WS_WD) + (size_t)(32 * nb) * DFF + 64 * kb, DFF, scr, lane); continue; } r -= I_8;
        { const int gg = r >> 3, kb = (r >> 2) & 1, nb = r & 3; tr_item(a.in[I_POOLW] + (size_t)gg * 16384, 128, 64 * kb, 32 * nb, nullptr, (bf16_t*)(ws + WS_PWT) + (size_t)gg * 16384 + (size_t)(32 * nb) * 128 + 64 * kb, 128, scr, lane); }
    }
    bf16_t* XB = (bf16_t*)(ws + WS_XB);
    for (int m = gw; m < MT; m += NGW) {
        const float* xrow = (m < MP) ? a.in[I_XP] + (size_t)m * D : a.in[I_XS] + (size_t)(m - MP) * D;
        const GAS f32x4* xr = (const GAS f32x4*)xrow + lane;
        f32x4 v[4]; float s = 0.f;
#pragma unroll
        for (int j = 0; j < 4; ++j) { v[j] = xr[64 * j]; s += (v[j].x * v[j].x + v[j].y * v[j].y) + (v[j].z * v[j].z + v[j].w * v[j].w); }
        const float rstd = 1.0f / sqrtf(wave_sum(s) * (1.f / D) + RMS_EPS);
        GAS unsigned long long* o8 = (GAS unsigned long long*)(XB + (size_t)m * D) + lane;
#pragma unroll
        for (int j = 0; j < 4; ++j) o8[64 * j] = (unsigned long long)pk2(v[j].x * rstd, v[j].y * rstd) | ((unsigned long long)pk2(v[j].z * rstd, v[j].w * rstd) << 32);
    }
}

#define MFMA32(a, b, c) __builtin_amdgcn_mfma_f32_32x32x16_bf16((a), (b), (c), 0, 0, 0)
constexpr int SROW = 528;
__device__ __forceinline__ void s5_unit(LAS unsigned char* lds, int g, int b, const Args& a, int tid, int wave, int lane) {
    const int SL = 128 * SROW;
    const int LE = 2 * 128 * SROW;
    const bf16_t* ussm = (const bf16_t*)(a.ws + WS_USSM);
    const unsigned char* src = (const unsigned char*)(ussm + ((size_t)g * MT + (size_t)b * TP) * 16);
#pragma unroll
    for (int ps = 0; ps < 8; ++ps) { const int o = ps * 8192 + tid * 16; *(LAS u32x4*)(lds + (o >> 9) * SROW + (o & 511)) = *(const GAS u32x4*)(src + o); }
    __syncthreads();
    const bf16_t* Mg = (const bf16_t*)(a.ws + WS_S5M) + (size_t)g * 131072; const bf16_t* Pg = Mg + 65536; const bf16_t* Qg = Mg + 98304;
    const int r = lane & 31, h = lane >> 5;
    {
        const int nt = wave & 3, ct0 = 2 * (wave >> 2);
        f32x16 c0, c1;
#pragma unroll
        for (int i = 0; i < 16; ++i) { c0[i] = 0.f; c1[i] = 0.f; }
#pragma unroll 4
        for (int ks = 0; ks < 16; ++ks) {
            const bf16x8 av = *(const GAS bf16x8*)(Pg + (32 * nt + r) * 256 + ks * 16 + 8 * h);
            const bf16x8 b0 = *(const LAS bf16x8*)(lds + (ct0 * 32 + r) * SROW + (ks * 16 + 8 * h) * 2);
            const bf16x8 b1 = *(const LAS bf16x8*)(lds + (ct0 * 32 + 32 + r) * SROW + (ks * 16 + 8 * h) * 2);
            c0 = MFMA32(av, b0, c0); c1 = MFMA32(av, b1, c1);
        }
#pragma unroll
        for (int q = 0; q < 4; ++q) { const int n = 32 * nt + 8 * q + 4 * h;
            *(LAS f32x4*)(lds + SL + (ct0 * 32 + r) * SROW + n * 4) = (f32x4){c0[4 * q], c0[4 * q + 1], c0[4 * q + 2], c0[4 * q + 3]};
            *(LAS f32x4*)(lds + SL + (ct0 * 32 + 32 + r) * SROW + n * 4) = (f32x4){c1[4 * q], c1[4 * q + 1], c1[4 * q + 2], c1[4 * q + 3]}; }
    }
    __syncthreads();
    {
        const float* tab = (const float*)(a.ws + WS_TAB);
        const int p = lane;
        const float l16r = tab[4096 + (g * 64 + p) * 2], l16i = tab[4096 + (g * 64 + p) * 2 + 1];
        const float l256r = tab[8192 + (g * 64 + p) * 2], l256i = tab[8192 + (g * 64 + p) * 2 + 1];
        float sr = 0.f, si = 0.f;
        for (int c = 0; c < 16; ++c) { const f32x2 x = *(const LAS f32x2*)(lds + SL + (16 * wave + c) * SROW + p * 8);
            const float t = l16r * sr - l16i * si + x.x; si = l16r * si + l16i * sr + x.y; sr = t; }
        *(LAS f32x2*)(lds + LE + (wave * 64 + p) * 8) = (f32x2){sr, si};
        __syncthreads();
        float cr = 0.f, ci = 0.f;
        for (int k = 0; k < wave; ++k) { const f32x2 e = *(const LAS f32x2*)(lds + LE + (k * 64 + p) * 8);
            const float t = l256r * cr - l256i * ci + e.x; ci = l256r * ci + l256i * cr + e.y; cr = t; }
        sr = cr; si = ci;
        for (int c = 0; c < 16; ++c) { const int row = 16 * wave + c; const f32x2 x = *(const LAS f32x2*)(lds + SL + row * SROW + p * 8);
            *(LAS unsigned*)(lds + SL + row * SROW + p * 4) = pk2(sr, si);
            const float t = l16r * sr - l16i * si + x.x; si = l16r * si + l16i * sr + x.y; sr = t; }
        if (wave == 7) { a.out[O_REP + (size_t)(b * 32 + g) * 64 + p] = sr; a.out[O_IMP + (size_t)(b * 32 + g) * 64 + p] = si; }
    }
    __syncthreads();
    {
        f32x16 c[4];
#pragma unroll
        for (int t = 0; t < 4; ++t)
#pragma unroll
            for (int i = 0; i < 16; ++i) c[t][i] = 0.f;
        const int nks = 2 * wave + 2;
        for (int ks = 0; ks < nks; ++ks) {
            const bf16x8 av = *(const GAS bf16x8*)(Mg + (32 * wave + r) * 256 + ks * 16 + 8 * h);
#pragma unroll
            for (int t = 0; t < 4; ++t) { const bf16x8 bv = *(const LAS bf16x8*)(lds + (t * 32 + r) * SROW + (ks * 16 + 8 * h) * 2); c[t] = MFMA32(av, bv, c[t]); }
        }
#pragma unroll 2
        for (int ks = 0; ks < 8; ++ks) {
            const bf16x8 av = *(const GAS bf16x8*)(Qg + (32 * wave + r) * 128 + ks * 16 + 8 * h);
#pragma unroll
            for (int t = 0; t < 4; ++t) { const bf16x8 bv = *(const LAS bf16x8*)(lds + SL + (t * 32 + r) * SROW + (ks * 16 + 8 * h) * 2); c[t] = MFMA32(av, bv, c[t]); }
        }
        bf16_t* zg = (bf16_t*)(a.ws + WS_Z) + ((size_t)g * MT + (size_t)b * TP) * 16;
#pragma unroll
        for (int t = 0; t < 4; ++t)
#pragma unroll
            for (int q = 0; q < 4; ++q) { const int n = 32 * wave + 8 * q + 4 * h, chunk = t * 32 + r;
                u32x2 o; o.x = pk2(gelu_tanh(c[t][4 * q]), gelu_tanh(c[t][4 * q + 1])); o.y = pk2(gelu_tanh(c[t][4 * q + 2]), gelu_tanh(c[t][4 * q + 3]));
                *(GAS u32x2*)(zg + (size_t)chunk * 256 + n) = o; }
    }
    __syncthreads();
}

__device__ __forceinline__ void s5_sample_pair(int idx, const Args& a, int lane) {
    const int g = idx & 31, b = idx >> 5, p = lane;
    const float* tab = (const float*)(a.ws + WS_TAB);
    const float lr = tab[(g * 64 + p) * 2], li = tab[(g * 64 + p) * 2 + 1];
    f32x4 bcv[8];
#pragma unroll
    for (int k = 0; k < 8; ++k) bcv[k] = *(const f32x4*)(tab + 16384 + (size_t)((g * 64 + p) * 16) * 2 + 4 * k);
    float cre[16], cim[16];
#pragma unroll
    for (int hp = 0; hp < 16; ++hp) { cre[hp] = a.in[I_CRE][(g * 16 + hp) * 64 + p]; cim[hp] = a.in[I_CIM][(g * 16 + hp) * 64 + p]; }
    const int idxl = ((lane & 1) << 3) | ((lane & 2) << 1) | ((lane & 4) >> 1) | ((lane & 8) >> 3);
    const float dsk = a.in[I_SD][g * 16 + idxl];
    float sr = a.in[I_SRE][(size_t)(b * 32 + g) * 64 + p], si = a.in[I_SIM][(size_t)(b * 32 + g) * 64 + p];
    const int row0 = MP + b * 4;
    const bf16_t* ussm = (const bf16_t*)(a.ws + WS_USSM);
    const float uval = bf1(ussm[((size_t)g * MT + row0) * 16 + lane]);
    bf16_t* zg = (bf16_t*)(a.ws + WS_Z);
#pragma unroll
    for (int t = 0; t < 4; ++t) {
        float bur = 0.f, bui = 0.f;
#pragma unroll
        for (int k = 0; k < 8; ++k) { const float u0 = __shfl(uval, t * 16 + 2 * k), u1 = __shfl(uval, t * 16 + 2 * k + 1);
            bur += bcv[k][0] * u0 + bcv[k][2] * u1; bui += bcv[k][1] * u0 + bcv[k][3] * u1; }
        { const float tr = lr * sr - li * si + bur; si = lr * si + li * sr + bui; sr = tr; }
        float v[16];
#pragma unroll
        for (int hp = 0; hp < 16; ++hp) v[hp] = cre[hp] * sr - cim[hp] * si;
#pragma unroll
        for (int i = 0; i < 8; ++i) { const bool up = lane & 1; const float keep = up ? v[i + 8] : v[i], send = up ? v[i] : v[i + 8]; v[i] = keep + __shfl_xor(send, 1); }
#pragma unroll
        for (int i = 0; i < 4; ++i) { const bool up = lane & 2; const float keep = up ? v[i + 4] : v[i], send = up ? v[i] : v[i + 4]; v[i] = keep + __shfl_xor(send, 2); }
#pragma unroll
        for (int i = 0; i < 2; ++i) { const bool up = lane & 4; const float keep = up ? v[i + 2] : v[i], send = up ? v[i] : v[i + 2]; v[i] = keep + __shfl_xor(send, 4); }
        { const bool up = lane & 8; const float keep = up ? v[1] : v[0], send = up ? v[0] : v[1]; v[0] = keep + __shfl_xor(send, 8); }
        float y = v[0]; y += __shfl_xor(y, 16); y += __shfl_xor(y, 32);
        y += dsk * __shfl(uval, t * 16 + idxl);
        if (lane < 16) zg[((size_t)g * MT + row0 + t) * 16 + idxl] = (bf16_t)f2bf(gelu_tanh(y));
    }
    a.out[O_RES + (size_t)(b * 32 + g) * 64 + p] = sr; a.out[O_IMS + (size_t)(b * 32 + g) * 64 + p] = si;
}

constexpr int PROW = 272;
template <int NT>
__device__ __forceinline__ void pool_mma(LAS unsigned char* df, int rt, int nt0, int g, size_t grow0, const Args& a, int lane) {
    const int r = lane & 31, h = lane >> 5;
    const bf16_t* pw = (const bf16_t*)(a.ws + WS_PWT) + (size_t)g * 16384;
    f32x16 c[NT];
#pragma unroll
    for (int t = 0; t < NT; ++t)
#pragma unroll
        for (int i = 0; i < 16; ++i) c[t][i] = 0.f;
#pragma unroll 2
    for (int ks = 0; ks < 8; ++ks) {
        const bf16x8 bv = *(const LAS bf16x8*)(df + (32 * rt + r) * PROW + (ks * 16 + 8 * h) * 2);
#pragma unroll
        for (int t = 0; t < NT; ++t) { const bf16x8 av = *(const GAS bf16x8*)(pw + (32 * (nt0 + t) + r) * 128 + ks * 16 + 8 * h); c[t] = MFMA32(av, bv, c[t]); }
    }
    bf16_t* ab = (bf16_t*)(a.ws + WS_AB);
    const size_t row = grow0 + 32 * rt + r;
#pragma unroll
    for (int t = 0; t < NT; ++t)
#pragma unroll
        for (int q = 0; q < 4; ++q) { const int n = 32 * (nt0 + t) + 8 * q + 4 * h; const f32x4 sc = *(const f32x4*)(a.in[I_PSCALE] + g * 128 + n);
            u32x2 o; o.x = pk2(c[t][4 * q] * sc[0], c[t][4 * q + 1] * sc[1]); o.y = pk2(c[t][4 * q + 2] * sc[2], c[t][4 * q + 3] * sc[3]);
            *(GAS u32x2*)(ab + row * 1024 + g * 128 + n) = o; }
}
__device__ __forceinline__ void pool_unit_prompt(LAS unsigned char* lds, int pm, int g, const Args& a, int tid, int wave, int lane) {
    const int r0 = pm * 256, bidx = r0 / TP, t0 = r0 % TP, w = 2 << g;
    LAS unsigned char* UT = lds; LAS unsigned char* DF = lds + 271 * PROW;
    const bf16_t* upool = (const bf16_t*)(a.ws + WS_UPOOL);
    for (int c = tid; c < 271 * 16; c += 512) { const int lr = c >> 4, cb = (c & 15) * 16;
        u32x4 v = (u32x4){0u, 0u, 0u, 0u};
        if (!(t0 == 0 && lr < 15)) v = *(const GAS u32x4*)((const unsigned char*)(upool + (size_t)(r0 - 15 + lr) * 512 + g * 128) + cb);
        *(LAS u32x4*)(UT + lr * PROW + cb) = v; }
    __syncthreads();
    {
        const int cp = tid & 63, seg = tid >> 6;
        float s0 = 0.f, s1 = 0.f;
        for (int k = 1; k < w; ++k) { const unsigned x = *(const LAS unsigned*)(UT + (15 + 32 * seg - k) * PROW + cp * 4); s0 += bflo(x); s1 += bfhi(x); }
        for (int rr = 0; rr < 32; ++rr) { const int t = 32 * seg + rr, lr = 15 + t;
            const unsigned x = *(const LAS unsigned*)(UT + lr * PROW + cp * 4); const float c0 = bflo(x), c1 = bfhi(x);
            s0 += c0; s1 += c1;
            const int pos = t0 + t; const float inv = 1.0f / (float)(pos + 1 < w ? pos + 1 : w);
            *(LAS unsigned*)(DF + t * PROW + cp * 4) = pk2(s0 * inv - c0, s1 * inv - c1);
            const unsigned y = *(const LAS unsigned*)(UT + (lr - (w - 1)) * PROW + cp * 4); s0 -= bflo(y); s1 -= bfhi(y); }
    }
    if (t0 == TP - 256) {
        for (int e = tid; e < 15 * 128; e += 512) { const int rr = e >> 7, c = e & 127;
            a.out[O_POOLP + ((size_t)bidx * 15 + rr) * 512 + g * 128 + c] = bf1(*(const LAS bf16_t*)(UT + (15 + 241 + rr) * PROW + c * 2)); }
    }
    __syncthreads();
    pool_mma<4>(DF, wave, 0, g, (size_t)r0, a, lane);
    __syncthreads();
}
__device__ __forceinline__ void pool_unit_sample(LAS unsigned char* lds, int su, int g, const Args& a, int tid, int wave, int lane) {
    const int w = 2 << g;
    LAS unsigned char* EX = lds; LAS unsigned char* DF = lds + 16 * 19 * PROW;
    const bf16_t* upool = (const bf16_t*)(a.ws + WS_UPOOL);
    const float* hist = a.in[I_SPOOL];
    for (int e = tid; e < 16 * 15 * 32; e += 512) { const int c4 = e & 31, hr = (e >> 5) % 15, sl = e / (32 * 15), seq = su * 16 + sl;
        const f32x4 v = *(const f32x4*)(hist + ((size_t)seq * 15 + hr) * 512 + g * 128 + c4 * 4);
        *(LAS u32x2*)(EX + (sl * 19 + hr) * PROW + c4 * 8) = (u32x2){pk2(v[0], v[1]), pk2(v[2], v[3])}; }
    for (int e = tid; e < 64 * 16; e += 512) { const int cb = (e & 15) * 16, row = e >> 4, sl = row >> 2, t = row & 3;
        *(LAS u32x4*)(EX + (sl * 19 + 15 + t) * PROW + cb) = *(const GAS u32x4*)((const unsigned char*)(upool + (size_t)(MP + su * 64 + row) * 512 + g * 128) + cb); }
    __syncthreads();
    const float inv = 1.0f / (float)w;
    for (int e = tid; e < 64 * 64; e += 512) { const int cp = e & 63, row = e >> 6, sl = row >> 2, t = row & 3; float s0 = 0.f, s1 = 0.f;
        for (int k = 0; k < w; ++k) { const unsigned x = *(const LAS unsigned*)(EX + (sl * 19 + 15 + t - k) * PROW + cp * 4); s0 += bflo(x); s1 += bfhi(x); }
        const unsigned x = *(const LAS unsigned*)(EX + (sl * 19 + 15 + t) * PROW + cp * 4);
        *(LAS unsigned*)(DF + row * PROW + cp * 4) = pk2(s0 * inv - bflo(x), s1 * inv - bfhi(x)); }
    for (int e = tid; e < 16 * 15 * 128; e += 512) { const int c = e & 127, rr = (e >> 7) % 15, sl = e / (128 * 15), seq = su * 16 + sl;
        const float v = rr < 11 ? hist[((size_t)seq * 15 + rr + 4) * 512 + g * 128 + c] : bf1(*(const LAS bf16_t*)(EX + (sl * 19 + 15 + rr - 11) * PROW + c * 2));
        a.out[O_POOLS + ((size_t)seq * 15 + rr) * 512 + g * 128 + c] = v; }
    __syncthreads();
    pool_mma<1>(DF, wave >> 2, wave & 3, g, (size_t)(MP + su * 64), a, lane);
    __syncthreads();
}

constexpr int N_PHASES = 9;
__global__ void __launch_bounds__(NWAVES * 64, 2) mk_fwd(Args a) {
    extern __shared__ __attribute__((aligned(16))) unsigned char lds_raw[];
    LAS unsigned char* lds = (LAS unsigned char*)lds_raw;
    volatile LAS unsigned* MISC = (volatile LAS unsigned*)(lds + MISC_OFF);
    const int tid = threadIdx.x, lane = tid & 63, wave = __builtin_amdgcn_readfirstlane(tid >> 6);
    const int G = gridDim.x, bx = blockIdx.x, vcu = (G % 8 == 0) ? (bx % 8) * (G / 8) + bx / 8 : bx;
    unsigned* ctl = (unsigned*)(a.ws + WS_CTL);
    if (tid < 64) MISC[tid] = 0u;
    __syncthreads();
    constexpr bool ONE = (MK_N_LAUNCHES == 1);
    XcdBarrier bar; bar.bar = ctl + CW_BAR; bar.x = 0; bar.st = nullptr;
    if (ONE) bar = xcd_barrier_post(ctl + CW_BAR, MISC + 8);
#define GRID_BAR() do { if (ONE) xcd_barrier(bar); } while (0)
    const int lo = a.ph_lo, hi = a.ph_hi;
#define IN(k) (lo <= (k) && (k) < hi)
#define BOTH(k) (IN(k) && IN((k) + 1))
    unsigned char* ws = a.ws;

    if (IN(0)) { p0_prologue(lds, a, vcu, G, tid, wave, lane); if (BOTH(0)) GRID_BAR(); }

    if (IN(1)) {
        pg8::Gemm g{(const bf16_t*)(ws + WS_XB), (const bf16_t*)(ws + WS_WIN), MT, INW, D}; pg8::StaticOrder S; S.init(MT, INW, G, bx);
        pg8::EpiIn E{(bf16_t*)(ws + WS_UPOOL), (bf16_t*)(ws + WS_USSM), (bf16_t*)(ws + WS_GATES)};
        pg8::gemm_phase<pg8::EpiIn, pg8::StaticOrder, true, true, false>(lds, g, S, E);
        if (BOTH(1)) GRID_BAR();
    }
    if (IN(2)) {
        for (int u = vcu; u < 256; u += G) s5_unit(lds, u >> 3, u & 7, a, tid, wave, lane);
        for (int u = vcu; u < 256; u += G) pool_unit_prompt(lds, u >> 2, u & 3, a, tid, wave, lane);
        for (int u = vcu; u < 32; u += G) pool_unit_sample(lds, u >> 2, u & 3, a, tid, wave, lane);
        for (int i = vcu * NWAVES + wave; i < 4096; i += G * NWAVES) s5_sample_pair(i, a, lane);
        if (BOTH(2)) GRID_BAR();
    }
    if (IN(3)) {
        pg8::Gemm g{(const bf16_t*)(ws + WS_Z), (const bf16_t*)(ws + WS_WGLU), MT, 512, 512}; pg8::StaticOrder S; S.init(MT, 512, G, bx);
        pg8::EpiGlu E{(const bf16_t*)(ws + WS_Z), a.in[I_GLUB], (bf16_t*)(ws + WS_AB)};
        pg8::gemm_phase<pg8::EpiGlu, pg8::StaticOrder, true, true, true>(lds, g, S, E);
        if (BOTH(3)) GRID_BAR();
    }
    if (IN(4)) {
        pg8::Gemm g{(const bf16_t*)(ws + WS_AB), (const bf16_t*)(ws + WS_WBR), MT, D, D}; pg8::StaticOrder S; S.init(MT, D, G, bx);
        pg8::EpiBr E{(const bf16_t*)(ws + WS_GATES), (bf16_t*)(ws + WS_MERGED)};
        pg8::gemm_phase<pg8::EpiBr, pg8::StaticOrder, true, true, false>(lds, g, S, E);
        if (BOTH(4)) GRID_BAR();
    }
    if (IN(5)) {
        pg8::Gemm g{(const bf16_t*)(ws + WS_MERGED), (const bf16_t*)(ws + WS_WOUT), MT, D, D}; pg8::StaticOrder S; S.init(MT, D, G, bx);
        pg8::EpiOut E{a.in[I_XP], a.in[I_XS], a.out + O_Y, (bf16_t*)(ws + WS_HB), (float*)(ws + WS_SSQ2)};
        pg8::gemm_phase<pg8::EpiOut, pg8::StaticOrder, true, true, false>(lds, g, S, E);
        if (BOTH(5)) GRID_BAR();
    }
    if (IN(6)) {
        pg8::Gemm g{(const bf16_t*)(ws + WS_HB), (const bf16_t*)(ws + WS_WGU), MT, 2 * DFF, D}; pg8::StaticOrder S; S.init(MT, 2 * DFF, G, bx);
        pg8::EpiUp E{(const float*)(ws + WS_SSQ2), (bf16_t*)(ws + WS_F)};
        pg8::gemm_phase<pg8::EpiUp, pg8::StaticOrder, true, true, false>(lds, g, S, E);
        if (BOTH(6)) GRID_BAR();
    }
    if (IN(7)) {
        pg8::Gemm g{(const bf16_t*)(ws + WS_F), (const bf16_t*)(ws + WS_WD), MT, D, DFF}; pg8::StaticOrder S; S.init(MT, D, G, bx);
        pg8::EpiDown E{a.out + O_Y, (float*)(ws + WS_SSQ3)};
        pg8::gemm_phase<pg8::EpiDown, pg8::StaticOrder, true, true, false>(lds, g, S, E);
        if (BOTH(7)) GRID_BAR();
    }
    if (IN(8)) {
        const float* ssq = (const float*)(ws + WS_SSQ3); const float* gn = a.in[I_NFIN];
        f32x4 gv[4];
#pragma unroll
        for (int j = 0; j < 4; ++j) gv[j] = *(const f32x4*)(gn + 4 * lane + 256 * j);
        for (int m = vcu * NWAVES + wave; m < MT; m += G * NWAVES) {
            const float r = 1.0f / sqrtf(ssq[m] * (1.f / D) + RMS_EPS);
            GAS f32x4* yr = (GAS f32x4*)(a.out + O_Y + (size_t)m * D) + lane;
#pragma unroll
            for (int j = 0; j < 4; ++j) { f32x4 v = yr[64 * j]; v = v * r * gv[j]; yr[64 * j] = v; }
        }
    }
#undef IN
#undef BOTH
#undef GRID_BAR
}

extern "C" void kernel_launch(void* const* d_in, const int* in_sizes, int n_in, void* d_out, int out_size, void* d_ws, size_t ws_size, hipStream_t stream) {
    static int grid = 0;
    if (grid == 0) {
        if (n_in != 27 || in_sizes[0] != MP * D || out_size != (int)O_END || ws_size < WS_END) {
            fprintf(stderr, "kernel_launch: unexpected shapes (n_in %d, in0 %d, out %d, ws %zu); nothing launched\n", n_in, n_in > 0 ? in_sizes[0] : -1, out_size, ws_size); grid = -1; return; }
        int dev = 0, cus = 0, per_cu = 0;
        if (hipGetDevice(&dev) != hipSuccess || hipDeviceGetAttribute(&cus, hipDeviceAttributeMultiprocessorCount, dev) != hipSuccess) { fprintf(stderr, "kernel_launch: device query failed\n"); grid = -1; return; }
        if (hipFuncSetAttribute((const void*)mk_fwd, hipFuncAttributeMaxDynamicSharedMemorySize, LDS_BYTES) != hipSuccess) { fprintf(stderr, "kernel_launch: hipFuncSetAttribute failed\n"); grid = -1; return; }
        if (hipOccupancyMaxActiveBlocksPerMultiprocessor(&per_cu, (const void*)mk_fwd, NWAVES * 64, LDS_BYTES) != hipSuccess || per_cu < 1) {
            fprintf(stderr, "kernel_launch: occupancy query reports %d workgroups per CU; nothing launched\n", per_cu); (void)hipGetLastError(); grid = -1; return; }
        grid = cus;
    }
    if (grid < 0) return;
    if (hipMemsetAsync((char*)d_ws + WS_CTL, 0, CTL_ZERO_BYTES, stream) != hipSuccess) { fprintf(stderr, "kernel_launch: hipMemsetAsync failed\n"); return; }
    Args a{};
    for (int i = 0; i < 27; ++i) a.in[i] = (const float*)d_in[i];
    a.out = (float*)d_out; a.ws = (unsigned char*)d_ws;
    if (MK_N_LAUNCHES == 1) {
        a.ph_lo = 0; a.ph_hi = N_PHASES; a.li = 0;
        void* params[] = {&a};
        const hipError_t le = hipLaunchCooperativeKernel((const void*)mk_fwd, dim3(grid), dim3(NWAVES * 64), params, LDS_BYTES, stream);
        if (le != hipSuccess) fprintf(stderr, "kernel_launch: cooperative launch failed: %s (grid %d)\n", hipGetErrorName(le), grid);
    } else {
        for (int li = 0; li < N_PHASES; ++li) { a.ph_lo = li; a.ph_hi = li + 1; a.li = li;
            hipLaunchKernelGGL(mk_fwd, dim3(grid), dim3(NWAVES * 64), LDS_BYTES, stream, a);
            const hipError_t le = hipPeekAtLastError();
            if (le != hipSuccess) { fprintf(stderr, "kernel_launch: launch %d failed: %s\n", li, hipGetErrorName(le)); break; } }
    }
}
```
